# Optimizing an MI355X kernel written in HIP

```python
import jax, jax.numpy as jnp
from jax import lax
import numpy as np

D_MODEL = 1024
BATCH = 16
SEQ = 4096
DEPTH = 1
DEC_BATCH = 8
DEC_SEQ = 16
PAST_LEN = 2048

CHUNK = 64
HEAD_DIM = 64
A_HEADS = 4
A_HEAD_DIM = 128
A_WIDTH = A_HEADS * A_HEAD_DIM
GMLP_CHUNK = 128
B_HEADS = 8
B_KV_HEADS = 2
GQA_GROUP = B_HEADS // B_KV_HEADS
B_WIDTH = B_HEADS * HEAD_DIM
KV_WIDTH = B_KV_HEADS * HEAD_DIM
WINDOW = 128
WINDOW_CHUNKS = WINDOW // CHUNK
MIX_WIDTH = A_WIDTH + B_WIDTH
IN_WIDTH = 2 * A_WIDTH + B_WIDTH + 2 * KV_WIDTH
D_FF = 2816
CONV_WIDTH = 3
ROPE_THETA = 10000.0
LN_EPS = 1e-5
RMS_EPS = 1e-6
ALPHA = (2 * DEPTH) ** 0.25
BETA = (8 * DEPTH) ** -0.25
ATTN_SCALE = HEAD_DIM ** -0.5

kernel_name = 'hymba_gmlp_swa_convffn_stream_step'


def layer_norm(x, g, b):
    xf = x.astype(jnp.float32)
    mu = jnp.mean(xf, -1, keepdims=True)
    var = jnp.mean(jnp.square(xf - mu), -1, keepdims=True)
    return ((xf - mu) * lax.rsqrt(var + LN_EPS) * g.astype(jnp.float32) + b.astype(jnp.float32)).astype(x.dtype)


def rms_norm(x, g):
    xf = x.astype(jnp.float32)
    ms = jnp.mean(jnp.square(xf), -1, keepdims=True)
    return (xf * lax.rsqrt(ms + RMS_EPS) * g.astype(jnp.float32)).astype(x.dtype)


def rope(x, pos):
    half = HEAD_DIM // 2
    inv = ROPE_THETA ** (-jnp.arange(half, dtype=jnp.float32) / half)
    ang = pos.astype(jnp.float32)[:, None] * inv[None, :]
    cos = jnp.cos(ang)[:, None, :]
    sin = jnp.sin(ang)[:, None, :]
    xf = x.astype(jnp.float32)
    x1, x2 = xf[..., :half], xf[..., half:]
    return jnp.concatenate([x1 * cos - x2 * sin, x2 * cos + x1 * sin], -1).astype(x.dtype)


def gmlp_mask():
    c = jnp.arange(GMLP_CHUNK) // CHUNK
    return c[:, None] >= c[None, :]


def mixer_inputs(x, pos, w_in, ln_g, ln_b):
    bn, t = x.shape[0], x.shape[1]
    z = x @ w_in
    za = jax.nn.gelu(z[..., :2 * A_WIDTH])
    u = za[..., :A_WIDTH].reshape(bn, t, A_HEADS, A_HEAD_DIM)
    gv = layer_norm(za[..., A_WIDTH:], ln_g, ln_b).reshape(bn, t, A_HEADS, A_HEAD_DIM)
    o = 2 * A_WIDTH
    q = rope(z[..., o:o + B_WIDTH].reshape(bn, t, B_HEADS, HEAD_DIM), pos)
    o += B_WIDTH
    k = rope(z[..., o:o + KV_WIDTH].reshape(bn, t, B_KV_HEADS, HEAD_DIM), pos)
    v = z[..., o + KV_WIDTH:].reshape(bn, t, B_KV_HEADS, HEAD_DIM)
    return u, gv, q, k, v


def gmlp_prompt(u, gv, w_s, b_s):
    bn, t = gv.shape[0], gv.shape[1]
    nc = t // GMLP_CHUNK
    vc = gv.reshape(bn, nc, GMLP_CHUNK, A_HEADS, A_HEAD_DIM)
    w = jnp.where(gmlp_mask()[None], w_s, 0)
    s = jnp.einsum('hij,bcjhd->bcihd', w, vc) + b_s.T[None, None, :, :, None]
    return (u * s.reshape(u.shape)).reshape(bn, t, A_WIDTH)


def gmlp_sample(u, gv, w_s, b_s):
    bn, s_len = gv.shape[0], gv.shape[1]
    w = jnp.where(gmlp_mask()[None], w_s, 0)[:, :s_len, :s_len]
    s = jnp.einsum('hij,bjhd->bihd', w, gv) + b_s.T[:s_len][None, :, :, None]
    return (u * s).reshape(bn, s_len, A_WIDTH)


def sink_probs(scores, sinks):
    sk = sinks.astype(jnp.float32).reshape(B_KV_HEADS, GQA_GROUP)[:, :, None, None]
    m = jnp.maximum(jnp.max(scores, -1, keepdims=True), sk)
    e = jnp.exp(scores - m)
    return e / (jnp.sum(e, -1, keepdims=True) + jnp.exp(sk - m))


def swa_prompt(q, k, v, sinks):
    bn, t = q.shape[0], q.shape[1]
    nc = t // CHUNK
    qc = q.reshape(bn, nc, CHUNK, B_KV_HEADS, GQA_GROUP, HEAD_DIM)
    pad = jnp.zeros((bn, WINDOW, B_KV_HEADS, HEAD_DIM), k.dtype)
    kp = jnp.concatenate([pad, k], 1).reshape(bn, nc + WINDOW_CHUNKS, CHUNK, B_KV_HEADS, HEAD_DIM)
    vp = jnp.concatenate([pad, v], 1).reshape(bn, nc + WINDOW_CHUNKS, CHUNK, B_KV_HEADS, HEAD_DIM)
    kb = jnp.concatenate([kp[:, i:i + nc] for i in range(WINDOW_CHUNKS + 1)], axis=2)
    vb = jnp.concatenate([vp[:, i:i + nc] for i in range(WINDOW_CHUNKS + 1)], axis=2)
    key_chunk = (jnp.arange(nc)[:, None] - WINDOW_CHUNKS
                 + jnp.repeat(jnp.arange(WINDOW_CHUNKS + 1), CHUNK)[None, :])
    valid = key_chunk >= 0
    scores = jnp.einsum('bcqkgd,bcskd->bckgqs', qc, kb).astype(jnp.float32) * ATTN_SCALE
    scores = jnp.where(valid[None, :, None, None, None, :], scores, -jnp.inf)
    p = sink_probs(scores, sinks).astype(vb.dtype)
    out = jnp.einsum('bckgqs,bcskd->bcqkgd', p, vb)
    return out.reshape(bn, t, B_WIDTH)


def swa_sample(q, k_all, v_all, sinks):
    bn, s_len = q.shape[0], q.shape[1]
    qg = q.reshape(bn, s_len, B_KV_HEADS, GQA_GROUP, HEAD_DIM)
    scores = jnp.einsum('bqkgd,bskd->bkgqs', qg, k_all).astype(jnp.float32) * ATTN_SCALE
    p = sink_probs(scores, sinks).astype(v_all.dtype)
    out = jnp.einsum('bkgqs,bskd->bqkgd', p, v_all)
    return out.reshape(bn, s_len, B_WIDTH)


def merge_and_ffn(x, ya, yb, conv_prev, norm_a_g, norm_b_g, w_out, ln1_g, ln1_b,
                  w_gate, w_up, conv_w, conv_b, w_down, ln2_g, ln2_b):
    t = x.shape[1]
    m = jnp.concatenate([rms_norm(ya, norm_a_g), rms_norm(yb, norm_b_g)], -1) @ w_out
    x1 = layer_norm(ALPHA * x + m, ln1_g, ln1_b)
    a = x1 @ w_gate
    ap = jnp.concatenate([conv_prev.astype(a.dtype), a], 1)
    c = sum(ap[:, i:i + t] * conv_w[i] for i in range(CONV_WIDTH)) + conv_b
    h = jax.nn.gelu(c) * (x1 @ w_up)
    x2 = layer_norm(ALPHA * x1 + h @ w_down, ln2_g, ln2_b)
    return x2, ap[:, -(CONV_WIDTH - 1):]


def setup_inputs(seed: int = 0) -> dict:
    key = jax.random.key(seed)
    ks = jax.random.split(key, 24)

    def nrm(k, shape, s):
        return jax.random.normal(k, shape, jnp.float32) * s

    return {
        'x_prompt': nrm(ks[0], (BATCH, SEQ, D_MODEL), 1.0),
        'x_sample': nrm(ks[1], (DEC_BATCH, DEC_SEQ, D_MODEL), 1.0),
        'cache_k': nrm(ks[2], (DEPTH, DEC_BATCH, WINDOW, B_KV_HEADS, HEAD_DIM), 1.0),
        'cache_v': nrm(ks[3], (DEPTH, DEC_BATCH, WINDOW, B_KV_HEADS, HEAD_DIM), 1.0),
        'state_ffn_conv': nrm(ks[4], (DEPTH, DEC_BATCH, CONV_WIDTH - 1, D_FF), 1.0),
        'w_in': nrm(ks[5], (DEPTH, D_MODEL, IN_WIDTH), D_MODEL ** -0.5),
        'gmlp_ln_g': 1.0 + nrm(ks[6], (DEPTH, A_WIDTH), 0.02),
        'gmlp_ln_b': nrm(ks[7], (DEPTH, A_WIDTH), 0.02),
        'gmlp_w_s': nrm(ks[8], (DEPTH, A_HEADS, GMLP_CHUNK, GMLP_CHUNK), GMLP_CHUNK ** -0.5),
        'gmlp_b_s': 1.0 + nrm(ks[9], (DEPTH, A_HEADS, GMLP_CHUNK), 0.02),
        'attn_sinks': nrm(ks[10], (DEPTH, B_HEADS), 0.5),
        'norm_a_g': 1.0 + nrm(ks[11], (DEPTH, A_WIDTH), 0.02),
        'norm_b_g': 1.0 + nrm(ks[12], (DEPTH, B_WIDTH), 0.02),
        'w_out': nrm(ks[13], (DEPTH, MIX_WIDTH, D_MODEL), BETA * MIX_WIDTH ** -0.5),
        'ln1_g': 1.0 + nrm(ks[14], (DEPTH, D_MODEL), 0.02),
        'ln1_b': nrm(ks[15], (DEPTH, D_MODEL), 0.02),
        'w_gate': nrm(ks[16], (DEPTH, D_MODEL, D_FF), D_MODEL ** -0.5),
        'w_up': nrm(ks[17], (DEPTH, D_MODEL, D_FF), D_MODEL ** -0.5),
        'conv_w': nrm(ks[18], (DEPTH, CONV_WIDTH, D_FF), CONV_WIDTH ** -0.5),
        'conv_b': nrm(ks[19], (DEPTH, D_FF), 0.02),
        'w_down': nrm(ks[20], (DEPTH, D_FF, D_MODEL), BETA * D_FF ** -0.5),
        'ln2_g': 1.0 + nrm(ks[21], (DEPTH, D_MODEL), 0.02),
        'ln2_b': nrm(ks[22], (DEPTH, D_MODEL), 0.02),
    }


def reference(x_prompt, x_sample, cache_k, cache_v, state_ffn_conv, w_in, gmlp_ln_g, gmlp_ln_b,
              gmlp_w_s, gmlp_b_s, attn_sinks, norm_a_g, norm_b_g, w_out, ln1_g, ln1_b,
              w_gate, w_up, conv_w, conv_b, w_down, ln2_g, ln2_b):
    xp, xs = x_prompt, x_sample
    bp, tp = xp.shape[0], xp.shape[1]
    ts = xs.shape[1]
    pos_p = jnp.arange(tp, dtype=jnp.int32)
    pos_s = PAST_LEN + jnp.arange(ts, dtype=jnp.int32)
    pk, pv, pc, sk, sv, sg, sc = [], [], [], [], [], [], []
    for l in range(DEPTH):
        ffn_args = (norm_a_g[l], norm_b_g[l], w_out[l], ln1_g[l], ln1_b[l],
                    w_gate[l], w_up[l], conv_w[l], conv_b[l], w_down[l], ln2_g[l], ln2_b[l])
        u, gv, q, k, v = mixer_inputs(xp, pos_p, w_in[l], gmlp_ln_g[l], gmlp_ln_b[l])
        ya = gmlp_prompt(u, gv, gmlp_w_s[l], gmlp_b_s[l])
        yb = swa_prompt(q, k, v, attn_sinks[l])
        conv0 = jnp.zeros((bp, CONV_WIDTH - 1, D_FF), xp.dtype)
        xp, conv_p = merge_and_ffn(xp, ya, yb, conv0, *ffn_args)
        pk.append(k[:, -WINDOW:])
        pv.append(v[:, -WINDOW:])
        pc.append(conv_p)
        u, gv, q, k, v = mixer_inputs(xs, pos_s, w_in[l], gmlp_ln_g[l], gmlp_ln_b[l])
        ya = gmlp_sample(u, gv, gmlp_w_s[l], gmlp_b_s[l])
        k_all = jnp.concatenate([cache_k[l].astype(k.dtype), k], 1)
        v_all = jnp.concatenate([cache_v[l].astype(v.dtype), v], 1)
        yb = swa_sample(q, k_all, v_all, attn_sinks[l])
        xs, conv_s = merge_and_ffn(xs, ya, yb, state_ffn_conv[l], *ffn_args)
        sk.append(k)
        sv.append(v)
        sg.append(gv)
        sc.append(conv_s)
    return (xp, xs, jnp.stack(pk), jnp.stack(pv), jnp.stack(pc),
            jnp.stack(sk), jnp.stack(sv), jnp.stack(sg), jnp.stack(sc))
```

```cpp
#include <hip/hip_runtime.h>
#include <hip/hip_cooperative_groups.h>
#include <cstdio>
#include <cstdint>
namespace cg = cooperative_groups;

#ifndef MK_MULTI
#define MK_MULTI 1
#endif

#define LAS __attribute__((address_space(3)))
typedef unsigned short bf16_t;
typedef short bf16x8 __attribute__((ext_vector_type(8)));
typedef short s16x4 __attribute__((ext_vector_type(4)));
typedef float f32x4 __attribute__((ext_vector_type(4)));
typedef unsigned u32x4 __attribute__((ext_vector_type(4)));
typedef unsigned u32x2 __attribute__((ext_vector_type(2)));

constexpr int DM = 1024, SEQ = 4096, MPR = 65536, SSEQ = 16, MSA = 128, MROWS = MPR + MSA;
constexpr int INW = 1792, FFD = 2816, GUW = 5632;
constexpr float ALPHA = 1.1892071150027210667f;
constexpr float LOG2E = 1.4426950408889634f;

constexpr size_t MiB = 1u << 20;
constexpr size_t WS_WINT = 0, WS_WOUTT = 4 * MiB, WS_WGUT = 6 * MiB, WS_WDNT = 18 * MiB, WS_WM = 24 * MiB, WS_ROPE = 25 * MiB, WS_GVP = 26 * MiB;
constexpr size_t WS_AHEAD = 30 * MiB, WS_BHEAD = 36 * MiB, WS_ATAIL = 42 * MiB, WS_ZS = 48 * MiB, WS_M1S = 49 * MiB, WS_C4S = 50 * MiB, WS_FS = 53 * MiB;
constexpr size_t WS_XB = 64 * MiB, WS_U = 193 * MiB, WS_GV = 257 * MiB, WS_Q = 321 * MiB, WS_K = 385 * MiB, WS_V = 401 * MiB;
constexpr size_t WS_HH = 64 * MiB;
constexpr size_t WS_MIX = 417 * MiB, WS_H1 = 546 * MiB, WS_X1 = 802 * MiB, WS_END = 931 * MiB;
static_assert(WS_HH + (size_t)MROWS * FFD * 2 <= WS_MIX, "HH overlay");
static_assert(WS_XB + (size_t)MROWS * DM * 2 <= WS_U && WS_MIX + (size_t)MROWS * DM * 2 <= WS_H1 && WS_X1 + (size_t)MROWS * DM * 2 <= WS_END, "ws map");

constexpr size_t O_YP = 0, O_YS = O_YP + (size_t)MPR * DM, O_PK = O_YS + (size_t)MSA * DM, O_PV = O_PK + 16 * 128 * 128, O_PC = O_PV + 16 * 128 * 128,
                 O_SK = O_PC + 16 * 2 * FFD, O_SV = O_SK + 8 * 16 * 128, O_SG = O_SV + 8 * 16 * 128, O_SC = O_SG + 8 * 16 * 512, O_END = O_SC + 8 * 2 * FFD;

constexpr int LDS_BYTES = 147456;
constexpr int RING_BYTES = 131072;

__device__ __forceinline__ unsigned f2bf(float f) { unsigned u = __builtin_bit_cast(unsigned, f); return (u + 0x7fffu + ((u >> 16) & 1u)) >> 16; }
__device__ __forceinline__ unsigned pk2(float lo, float hi) { return f2bf(lo) | (f2bf(hi) << 16); }
__device__ __forceinline__ unsigned cvt_pk_bf16(float lo, float hi) { unsigned r; asm volatile("v_cvt_pk_bf16_f32 %0, %1, %2" : "=v"(r) : "v"(lo), "v"(hi)); return r; }
__device__ __forceinline__ float bf_lo(unsigned w) { return __builtin_bit_cast(float, w << 16); }
__device__ __forceinline__ float bf_hi(unsigned w) { return __builtin_bit_cast(float, w & 0xffff0000u); }
__device__ __forceinline__ float bf2f(bf16_t h) { return __builtin_bit_cast(float, (unsigned)h << 16); }
__device__ __forceinline__ float gelu_f(float x) {
    const float u = x * (0.7978845608028654f + 0.035677408136300125f * x * x);
    const float e = __builtin_amdgcn_exp2f(-2.8853900817779268f * u);
    return x * __builtin_amdgcn_rcpf(1.0f + e);
}
__device__ __forceinline__ f32x4 gelu4(f32x4 v) { return (f32x4){gelu_f(v[0]), gelu_f(v[1]), gelu_f(v[2]), gelu_f(v[3])}; }
__device__ __forceinline__ u32x2 pack4(f32x4 v) { u32x2 w; w.x = cvt_pk_bf16(v[0], v[1]); w.y = cvt_pk_bf16(v[2], v[3]); return w; }
__host__ __device__ __forceinline__ int swap45(int p) { return (p & ~0x30) | ((p & 0x10) << 1) | ((p & 0x20) >> 1); }
__device__ __forceinline__ float wave_sum(float v) {
#pragma unroll
    for (int o = 1; o < 64; o <<= 1) v += __shfl_xor(v, o);
    return v;
}

namespace pg8 {
constexpr int BM = 256, BK = 64, HALF = 128, HTB = HALF * BK * 2, NXCD = 8, WGM = 8;
__host__ __device__ __forceinline__ int lds_byte(int r, int c) { const int st = (r >> 4) * 2 + (c >> 5), rr = r & 15, cc = c & 31, ob = rr * 64 + cc * 2; return st * 1024 + (ob ^ (((ob >> 9) & 1) << 5)); }
__host__ __device__ __forceinline__ void stage_rc(int b, int& R, int& C) { const int st = b / 1024, sb = b % 1024, swz = sb ^ (((sb >> 9) & 1) << 5); R = (st >> 1) * 16 + swz / 64; C = (st & 1) * 32 + (swz % 64) / 2; }
struct Unit { int pm, pn; };
struct Gemm { const bf16_t* A; const bf16_t* Bt; int M, N, K; };
struct StaticOrder {
    int nM, nN, nwg, G, c;
    __device__ void init(int M, int N, int G_, int c_) { nM = M / BM; nN = N / BM; nwg = nM * nN; G = G_; c = c_; }
    __device__ bool next(int i, Unit& u) const {
        const long L = (long)i * G + c; if (L >= nwg) return false;
        int wgid = (int)L; { const int q = nwg / NXCD, r = nwg % NXCD, xcd = wgid % NXCD, off = wgid / NXCD; wgid = (xcd < r ? xcd * (q + 1) : r * (q + 1) + (xcd - r) * q) + off; }
        const int nig = WGM * nN, gid = wgid / nig, fm = gid * WGM, gsz = (nM - fm) < WGM ? (nM - fm) : WGM;
        u.pm = fm + ((wgid % nig) % gsz); u.pn = (wgid % nig) / gsz; return true;
    }
};
template <class Epi>
__device__ __forceinline__ void gemm_phase(LAS unsigned char* lds, const Gemm g, const StaticOrder& S, const Epi& E) {
    const int tid = threadIdx.x, wid = __builtin_amdgcn_readfirstlane(tid >> 6), lane = tid & 63, wr = wid >> 2, wc = wid & 3, fr = lane & 15, fq = lane >> 4;
    const int K = g.K, nt = K / BK;
    unsigned voffA[2];
#pragma unroll
    for (int i = 0; i < 2; ++i) { int R, C; stage_rc(tid * 16 + i * 8192, R, C); voffA[i] = (unsigned)(R * K + C) * 2u; }
    const size_t kstep = (size_t)(BK * 2);
    const size_t hstep = (size_t)HALF * K * 2;
    const size_t tstep = 2 * hstep;
    const unsigned ldsw = (unsigned)wid * 1024u;
    const int aoff = lds_byte(wr * 64 + fr, fq * 8), boff = lds_byte(wc * 32 + fr, fq * 8);
#define PG8_SA(b, h) (((b) * 2 + (h)) * HTB)
#define PG8_SB(b, h) ((4 + (b) * 2 + (h)) * HTB)
#define PG8_STAGE(bufoff, gbase, voff) do { _Pragma("unroll") for (int _i = 0; _i < 2; ++_i) \
        __builtin_amdgcn_global_load_lds((const unsigned*)((const char*)(gbase) + (voff)[_i]), (LAS unsigned*)(lds + (bufoff) + ldsw + _i * 8192), 16, 0, 0); } while (0)
#define PG8_LDA(dst, b, h) do { _Pragma("unroll") for (int m = 0; m < 4; ++m) _Pragma("unroll") for (int k = 0; k < 2; ++k) dst[m][k] = *(const LAS bf16x8*)(lds + PG8_SA(b, h) + aoff + m * 2048 + k * 1024); } while (0)
#define PG8_LDB(dst, b, h) do { _Pragma("unroll") for (int n = 0; n < 2; ++n) _Pragma("unroll") for (int k = 0; k < 2; ++k) dst[n][k] = *(const LAS bf16x8*)(lds + PG8_SB(b, h) + boff + n * 2048 + k * 1024); } while (0)
#define PG8_MMA(ai, bj, At, Bt) do { __builtin_amdgcn_s_setprio(1); _Pragma("unroll") for (int m = 0; m < 4; ++m) _Pragma("unroll") for (int n = 0; n < 2; ++n) _Pragma("unroll") for (int k = 0; k < 2; ++k) \
        acc[ai][bj][m][n] = __builtin_amdgcn_mfma_f32_16x16x32_bf16(Bt[n][k], At[m][k], acc[ai][bj][m][n], 0, 0, 0); __builtin_amdgcn_s_setprio(0); } while (0)
#define PG8_WAIT_V(n) asm volatile("s_waitcnt vmcnt(" #n ")" ::: "memory")
#define PG8_WAIT_L(n) asm volatile("s_waitcnt lgkmcnt(" #n ")" ::: "memory")
#define PG8_BAR __builtin_amdgcn_s_barrier()
#define PG8_SCHED __builtin_amdgcn_sched_barrier(0)
    Unit cur, nxt; int ui = 0;
    if (!S.next(0, cur)) return;
    f32x4 acc[2][2][4][2];
#pragma unroll
    for (int a = 0; a < 2; ++a)
#pragma unroll
        for (int b = 0; b < 2; ++b)
#pragma unroll
            for (int m = 0; m < 4; ++m)
#pragma unroll
                for (int n = 0; n < 2; ++n) acc[a][b][m][n] = (f32x4){0.f, 0.f, 0.f, 0.f};
    bf16x8 At[4][2], B0[2][2], B1[2][2];
    const char* cA = (const char*)g.A + (size_t)cur.pm * tstep; const char* cB = (const char*)g.Bt + (size_t)cur.pn * tstep;
    PG8_STAGE(PG8_SB(0, 0), cB, voffA); PG8_STAGE(PG8_SB(0, 1), cB + hstep, voffA); PG8_STAGE(PG8_SA(0, 0), cA, voffA); PG8_STAGE(PG8_SA(0, 1), cA + hstep, voffA);
    if (wr == 1) PG8_BAR;
    PG8_WAIT_V(2); PG8_BAR;
    PG8_STAGE(PG8_SB(1, 0), cB + kstep, voffA); PG8_STAGE(PG8_SA(1, 0), cA + kstep, voffA); PG8_STAGE(PG8_SB(1, 1), cB + hstep + kstep, voffA);
    PG8_WAIT_V(6); PG8_BAR;
    for (;;) {
        const bool has_next = S.next(ui + 1, nxt);
        const char* nA = has_next ? (const char*)g.A + (size_t)nxt.pm * tstep : cA; const char* nB = has_next ? (const char*)g.Bt + (size_t)nxt.pn * tstep : cB;
        for (int t = 0; t < nt; t += 2) {
            const bool last = (t == nt - 2);
            const char* a1 = cA + (size_t)(t + 1) * kstep;
            const char* a2 = last ? nA : cA + (size_t)(t + 2) * kstep; const char* b2 = last ? nB : cB + (size_t)(t + 2) * kstep;
            const char* a3 = a2 + kstep; const char* b3 = b2 + kstep;
            PG8_LDB(B0, 0, 0); PG8_LDB(B1, 0, 1); PG8_SCHED; PG8_LDA(At, 0, 0); PG8_STAGE(PG8_SA(1, 1), a1 + hstep, voffA);
            PG8_WAIT_V(8); PG8_WAIT_L(0); PG8_BAR; PG8_MMA(0, 0, At, B0); PG8_MMA(0, 1, At, B1); PG8_BAR; PG8_SCHED;
            PG8_LDA(At, 0, 1); PG8_STAGE(PG8_SB(0, 0), b2, voffA); PG8_STAGE(PG8_SB(0, 1), b2 + hstep, voffA); PG8_STAGE(PG8_SA(0, 0), a2, voffA);
            PG8_WAIT_V(8); PG8_WAIT_L(0); PG8_BAR; PG8_MMA(1, 0, At, B0); PG8_MMA(1, 1, At, B1); PG8_BAR; PG8_SCHED;
            PG8_LDB(B0, 1, 0); PG8_LDB(B1, 1, 1); PG8_SCHED; PG8_LDA(At, 1, 0); PG8_STAGE(PG8_SA(0, 1), a2 + hstep, voffA);
            PG8_WAIT_V(8); PG8_WAIT_L(0); PG8_BAR; PG8_MMA(0, 0, At, B0); PG8_MMA(0, 1, At, B1); PG8_BAR; PG8_SCHED;
            PG8_LDA(At, 1, 1); PG8_STAGE(PG8_SB(1, 0), b3, voffA); PG8_STAGE(PG8_SB(1, 1), b3 + hstep, voffA); PG8_STAGE(PG8_SA(1, 0), a3, voffA);
            PG8_WAIT_V(8); PG8_WAIT_L(0); PG8_BAR; PG8_MMA(1, 0, At, B0); PG8_MMA(1, 1, At, B1); PG8_BAR; PG8_SCHED;
        }
        if (wr == 0) PG8_BAR;
        E(acc, cur, wr, wc, fr, fq, lane, lds + RING_BYTES);
        if (!has_next) break;
#pragma unroll
        for (int a = 0; a < 2; ++a)
#pragma unroll
            for (int b = 0; b < 2; ++b)
#pragma unroll
                for (int m = 0; m < 4; ++m)
#pragma unroll
                    for (int n = 0; n < 2; ++n) acc[a][b][m][n] = (f32x4){0.f, 0.f, 0.f, 0.f};
        cur = nxt; cA = nA; cB = nB; ++ui;
        if (wr == 1) PG8_BAR;
    }
    PG8_WAIT_V(0);
    PG8_BAR;
#undef PG8_SA
#undef PG8_SB
#undef PG8_STAGE
#undef PG8_LDA
#undef PG8_LDB
#undef PG8_MMA
}
}
using pg8::Unit;

struct Epi1 {
    bf16_t *U, *GV, *Q, *KB, *VB; float* GVP; const float* rope; float* out;
    __device__ __forceinline__ void operator()(const f32x4 (&acc)[2][2][4][2], const Unit& u, int wr, int wc, int fr, int fq, int lane, LAS unsigned char* scr) const {
        const int pn = u.pn, rbase = u.pm * 256 + wr * 64 + fr, cw0 = wc * 32 + fq * 4;
        if (pn < 2) {
#pragma unroll
            for (int ai = 0; ai < 2; ++ai)
#pragma unroll
                for (int m = 0; m < 4; ++m) { bf16_t* rp = U + (size_t)(rbase + ai * 128 + m * 16) * 512 + pn * 256 + cw0;
#pragma unroll
                    for (int bj = 0; bj < 2; ++bj)
#pragma unroll
                        for (int n = 0; n < 2; ++n) *(u32x2*)(rp + bj * 128 + n * 16) = pack4(gelu4(acc[ai][bj][m][n])); }
        } else if (pn < 4) {
#pragma unroll
            for (int ai = 0; ai < 2; ++ai)
#pragma unroll
                for (int m = 0; m < 4; ++m) { const int row = rbase + ai * 128 + m * 16; bf16_t* rp = GV + (size_t)row * 512 + (pn - 2) * 256 + cw0; float s = 0.f, q = 0.f;
#pragma unroll
                    for (int bj = 0; bj < 2; ++bj)
#pragma unroll
                        for (int n = 0; n < 2; ++n) { const f32x4 v = gelu4(acc[ai][bj][m][n]); s += (v[0] + v[1]) + (v[2] + v[3]); q += (v[0] * v[0] + v[1] * v[1]) + (v[2] * v[2] + v[3] * v[3]);
                            *(u32x2*)(rp + bj * 128 + n * 16) = pack4(v); }
                    s += __shfl_xor(s, 16); s += __shfl_xor(s, 32); q += __shfl_xor(q, 16); q += __shfl_xor(q, 32);
                    if (fq == 0) { float* gp = GVP + (size_t)row * 16 + ((pn - 2) * 4 + wc) * 2; gp[0] = s; gp[1] = q; } }
        } else {
            const int dlo = (wc & 1) * 16 + fq * 4;
#pragma unroll
            for (int ai = 0; ai < 2; ++ai)
#pragma unroll
                for (int m = 0; m < 4; ++m) { const int row = rbase + ai * 128 + m * 16, t = row & (SEQ - 1), b = row >> 12;
                    const f32x4 cs = *(const f32x4*)(rope + (size_t)t * 32 + dlo), sn = *(const f32x4*)(rope + (size_t)SEQ * 32 + (size_t)t * 32 + dlo);
#pragma unroll
                    for (int bj = 0; bj < 2; ++bj) {
                        if (pn == 6 && bj == 1) {
#pragma unroll
                            for (int n = 0; n < 2; ++n) { const int vc = 64 * (wc >> 1) + 32 * n + dlo; const f32x4 v = acc[ai][1][m][n];
                                *(u32x2*)(VB + (size_t)row * 128 + vc) = pack4(v);
                                if (t >= SEQ - 128) *(f32x4*)(out + O_PV + ((size_t)(b * 128 + t - (SEQ - 128)) * 128 + vc)) = v; }
                        } else {
                            const f32x4 x1 = acc[ai][bj][m][0], x2 = acc[ai][bj][m][1];
                            f32x4 o1 = x1 * cs - x2 * sn, o2 = x2 * cs + x1 * sn;
                            if (pn < 6) { const int head = (pn - 4) * 4 + 2 * bj + (wc >> 1); bf16_t* qp = Q + (size_t)row * 512 + head * 64 + dlo;
                                o1 = o1 * 0.125f; o2 = o2 * 0.125f; *(u32x2*)qp = pack4(o1); *(u32x2*)(qp + 32) = pack4(o2);
                            } else { const int kc = 64 * (wc >> 1) + dlo; bf16_t* kp = KB + (size_t)row * 128 + kc; *(u32x2*)kp = pack4(o1); *(u32x2*)(kp + 32) = pack4(o2);
                                if (t >= SEQ - 128) { float* op = out + O_PK + ((size_t)(b * 128 + t - (SEQ - 128)) * 128 + kc); *(f32x4*)op = o1; *(f32x4*)(op + 32) = o2; } }
                        }
                    } }
        }
    }
};
struct Epi3 {
    const float* x; float* H1;
    __device__ __forceinline__ void operator()(const f32x4 (&acc)[2][2][4][2], const Unit& u, int wr, int wc, int fr, int fq, int lane, LAS unsigned char* scr) const {
        const int rbase = u.pm * 256 + wr * 64 + fr, c0 = u.pn * 256 + wc * 32 + fq * 4;
#pragma unroll
        for (int ai = 0; ai < 2; ++ai)
#pragma unroll
            for (int m = 0; m < 4; ++m) { const size_t off = (size_t)(rbase + ai * 128 + m * 16) * DM + c0;
#pragma unroll
                for (int bj = 0; bj < 2; ++bj)
#pragma unroll
                    for (int n = 0; n < 2; ++n) { const f32x4 xv = *(const f32x4*)(x + off + bj * 128 + n * 16); *(f32x4*)(H1 + off + bj * 128 + n * 16) = xv * ALPHA + acc[ai][bj][m][n]; } }
    }
};
struct Epi5 {
    const bf16_t* X1; float* H2;
    __device__ __forceinline__ void operator()(const f32x4 (&acc)[2][2][4][2], const Unit& u, int wr, int wc, int fr, int fq, int lane, LAS unsigned char* scr) const {
        const int rbase = u.pm * 256 + wr * 64 + fr, c0 = u.pn * 256 + wc * 32 + fq * 4;
#pragma unroll
        for (int ai = 0; ai < 2; ++ai)
#pragma unroll
            for (int m = 0; m < 4; ++m) { const size_t off = (size_t)(rbase + ai * 128 + m * 16) * DM + c0;
#pragma unroll
                for (int bj = 0; bj < 2; ++bj)
#pragma unroll
                    for (int n = 0; n < 2; ++n) { const u32x2 w = *(const u32x2*)(X1 + off + bj * 128 + n * 16); const f32x4 xv = (f32x4){bf_lo(w.x), bf_hi(w.x), bf_lo(w.y), bf_hi(w.y)};
                        *(f32x4*)(H2 + off + bj * 128 + n * 16) = xv * ALPHA + acc[ai][bj][m][n]; } }
    }
};
struct Epi4 {
    bf16_t* HH; float *AHEAD, *BHEAD, *ATAIL; const float *cw, *cb;
    __device__ __forceinline__ void operator()(const f32x4 (&acc)[2][2][4][2], const Unit& u, int wr, int wc, int fr, int fq, int lane, LAS unsigned char* scr) const {
        LAS float* halo = (LAS float*)scr;
        const int colw = wc * 32 + fq * 4;
        if (fr >= 14) {
#pragma unroll
            for (int ai = 0; ai < 2; ++ai)
#pragma unroll
                for (int n = 0; n < 2; ++n) *(LAS f32x4*)(halo + ((2 * ai + wr) * 2 + (fr - 14)) * 128 + colw + n * 16) = acc[ai][0][3][n];
        }
        asm volatile("s_waitcnt lgkmcnt(0)" ::: "memory"); __builtin_amdgcn_s_barrier(); asm volatile("" ::: "memory");
        const int src1 = (lane & 48) | ((fr + 15) & 15), src2 = (lane & 48) | ((fr + 14) & 15);
#pragma unroll
        for (int ai = 0; ai < 2; ++ai) { const int strip = 2 * ai + wr;
#pragma unroll
            for (int n = 0; n < 2; ++n) { const int f0 = u.pn * 128 + colw + n * 16;
                f32x4 hv = (f32x4){0.f, 0.f, 0.f, 0.f};
                if (strip > 0 && fr >= 14) hv = *(const LAS f32x4*)(halo + ((strip - 1) * 2 + (fr - 14)) * 128 + colw + n * 16);
                const f32x4 w0 = *(const f32x4*)(cw + f0), w1 = *(const f32x4*)(cw + FFD + f0), w2 = *(const f32x4*)(cw + 2 * FFD + f0), cbv = *(const f32x4*)(cb + f0);
                f32x4 r1p, r2p;
#pragma unroll
                for (int j = 0; j < 4; ++j) { r1p[j] = __shfl(hv[j], src1); r2p[j] = __shfl(hv[j], src2); }
#pragma unroll
                for (int m = 0; m < 4; ++m) { const f32x4 cur = acc[ai][0][m][n], up = acc[ai][1][m][n]; f32x4 r1c, r2c, h;
#pragma unroll
                    for (int j = 0; j < 4; ++j) { r1c[j] = __shfl(cur[j], src1); r2c[j] = __shfl(cur[j], src2);
                        const float p1 = fr >= 1 ? r1c[j] : r1p[j], p2 = fr >= 2 ? r2c[j] : r2p[j];
                        const float c = w0[j] * p2 + w1[j] * p1 + w2[j] * cur[j] + cbv[j];
                        h[j] = gelu_f(c) * up[j]; }
                    const int rt = ai * 128 + wr * 64 + m * 16 + fr;
                    *(u32x2*)(HH + (size_t)(u.pm * 256 + rt) * FFD + f0) = pack4(h);
                    if (rt < 2) { *(f32x4*)(AHEAD + (size_t)(u.pm * 2 + rt) * FFD + f0) = cur; *(f32x4*)(BHEAD + (size_t)(u.pm * 2 + rt) * FFD + f0) = up; }
                    if (rt >= 254) *(f32x4*)(ATAIL + (size_t)(u.pm * 2 + rt - 254) * FFD + f0) = cur;
                    r1p = r1c; r2p = r2c; }
            } }
    }
};

__device__ __forceinline__ void skinny_gemm(const bf16_t* A, const bf16_t* Bt, float* C, int N, int K, int wid, int lane) {
    const int fr = lane & 15, fq = lane >> 4;
    for (int un = blockIdx.x; un < N / 16; un += gridDim.x) {
        const bf16_t* ap = A + (size_t)(16 * wid + fr) * K + 8 * fq; const bf16_t* bp = Bt + (size_t)(16 * un + fr) * K + 8 * fq;
        f32x4 acc = (f32x4){0.f, 0.f, 0.f, 0.f};
        for (int k0 = 0; k0 < K; k0 += 256) {
            bf16x8 a[8], b[8];
#pragma unroll
            for (int i = 0; i < 8; ++i) { a[i] = *(const bf16x8*)(ap + k0 + 32 * i); b[i] = *(const bf16x8*)(bp + k0 + 32 * i); }
#pragma unroll
            for (int i = 0; i < 8; ++i) acc = __builtin_amdgcn_mfma_f32_16x16x32_bf16(a[i], b[i], acc, 0, 0, 0);
        }
#pragma unroll
        for (int r = 0; r < 4; ++r) C[(size_t)(16 * wid + 4 * fq + r) * N + 16 * un + fr] = acc[r];
    }
}

struct Args { const float* in[23]; float* out; unsigned char* ws; int ph_lo, ph_hi; };
enum { I_XP = 0, I_XS, I_CK, I_CV, I_ST, I_WIN, I_GLG, I_GLB, I_WS, I_BS, I_SINK, I_NAG, I_NBG, I_WOUT, I_L1G, I_L1B, I_WG, I_WU, I_CW, I_CB, I_WD, I_L2G, I_L2B };

__device__ __forceinline__ void transpose_item(const float* W, int ldw, int srccol, const float* ga, const float* gb, bf16_t* WT, int K, int drow0, int k0, float* scr, int lane) {
#pragma unroll 8
    for (int i = 0; i < 32; ++i) { const int kk = 2 * i + (lane >> 5), k = k0 + kk; float v = W[(size_t)k * ldw + srccol];
        if (ga) v *= (k < 512) ? ga[k] : gb[k - 512];
        scr[kk * 33 + (lane & 31)] = v; }
    asm volatile("s_waitcnt lgkmcnt(0)" ::: "memory");
    const int c = lane & 7;
#pragma unroll
    for (int j = 0; j < 4; ++j) { const int n = (lane >> 3) + 8 * j; const float* s = scr + (8 * c) * 33 + n;
        u32x4 o; o.x = pk2(s[0 * 33], s[1 * 33]); o.y = pk2(s[2 * 33], s[3 * 33]); o.z = pk2(s[4 * 33], s[5 * 33]); o.w = pk2(s[6 * 33], s[7 * 33]);
        *(u32x4*)(WT + (size_t)(drow0 + n) * K + k0 + 8 * c) = o; }
    asm volatile("s_waitcnt lgkmcnt(0)" ::: "memory");
}
__device__ __forceinline__ void p0_prologue(const Args& a, unsigned char* lds, int tid, int wid, int lane) {
    unsigned char* ws = a.ws;
    const int G = gridDim.x, gw = blockIdx.x * 8 + wid, NGW = G * 8; const size_t gt = (size_t)blockIdx.x * 512 + tid, NT = (size_t)G * 512;
    float* scr = (float*)(lds + wid * 8448);
    bf16_t* WINT = (bf16_t*)(ws + WS_WINT); bf16_t* WOUTT = (bf16_t*)(ws + WS_WOUTT); bf16_t* WGUT = (bf16_t*)(ws + WS_WGUT); bf16_t* WDNT = (bf16_t*)(ws + WS_WDNT);
    constexpr int I1 = 16 * (INW / 32), I2 = 16 * (DM / 32), I3 = 16 * (GUW / 32), I4 = (FFD / 64) * (DM / 32);
    for (int it = gw; it < I1 + I2 + I3 + I4; it += NGW) {
        int r = it;
        if (r < I1) { const int nb = r % (INW / 32), kb = r / (INW / 32), n = nb * 32 + (lane & 31); const int src = n < 1024 ? n : ((n & ~255) | swap45(n & 255));
            transpose_item(a.in[I_WIN], INW, src, nullptr, nullptr, WINT, DM, nb * 32, kb * 64, scr, lane); continue; } r -= I1;
        if (r < I2) { const int nb = r % (DM / 32), kb = r / (DM / 32);
            transpose_item(a.in[I_WOUT], DM, nb * 32 + (lane & 31), a.in[I_NAG], a.in[I_NBG], WOUTT, DM, nb * 32, kb * 64, scr, lane); continue; } r -= I2;
        if (r < I3) { const int nb = r % (GUW / 32), kb = r / (GUW / 32), n0 = nb * 32, pn = n0 >> 8, p = n0 & 255;
            const float* W = (p < 128) ? a.in[I_WG] : a.in[I_WU];
            transpose_item(W, FFD, pn * 128 + (p & 127) + (lane & 31), nullptr, nullptr, WGUT, DM, n0, kb * 64, scr, lane); continue; } r -= I3;
        { const int nb = r % (DM / 32), kb = r / (DM / 32);
            transpose_item(a.in[I_WD], DM, nb * 32 + (lane & 31), nullptr, nullptr, WDNT, FFD, nb * 32, kb * 64, scr, lane); }
    }
    bf16_t* XB = (bf16_t*)(ws + WS_XB);
    for (size_t i = gt; i < (size_t)MROWS * DM / 8; i += NT) { const size_t e = i * 8; const float* src = e < (size_t)MPR * DM ? a.in[I_XP] + e : a.in[I_XS] + (e - (size_t)MPR * DM);
        const f32x4 v0 = *(const f32x4*)src, v1 = *(const f32x4*)(src + 4); u32x4 o; o.x = pk2(v0[0], v0[1]); o.y = pk2(v0[2], v0[3]); o.z = pk2(v1[0], v1[1]); o.w = pk2(v1[2], v1[3]);
        *(u32x4*)(XB + e) = o; }
    float* rope = (float*)(ws + WS_ROPE);
    for (size_t i = gt; i < (size_t)SEQ * 32; i += NT) { const int t = (int)(i >> 5), k = (int)(i & 31); const double inv = pow(10000.0, -(double)k / 32.0), ang = (double)t * inv;
        rope[i] = (float)cos(ang); rope[(size_t)SEQ * 32 + i] = (float)sin(ang); }
    bf16_t* WM = (bf16_t*)(ws + WS_WM);
    for (size_t i = gt; i < 4 * 128 * 128; i += NT) { const int j = (int)(i & 127), ii = (int)((i >> 7) & 127); WM[i] = (bf16_t)(((ii >> 6) >= (j >> 6)) ? f2bf(a.in[I_WS][i]) : 0u); }
}

struct P2Args { const bf16_t *U, *GV, *Q, *KB, *VB, *WM; const float *GVP, *lng, *lnb, *bs, *sinks; bf16_t* MIX; };
__device__ __forceinline__ void mixer_item(unsigned char* lds, const P2Args& A, int item, int tid, int wid, int lane) {
    const int b = item >> 6, c = item & 63, row0 = b * SEQ + c * 64, i0 = (c & 1) * 64, j0row = row0 - i0, nj = i0 + 64;
    const int fr = lane & 15, fq = lane >> 4;
    bf16_t* gvT = (bf16_t*)lds;
    float* stat = (float*)(lds + 139264);
    float* ssqA = (float*)(lds + 140288);
    float* ssqB = (float*)(lds + 142336);
    if (tid < nj) { const float* p = A.GVP + (size_t)(j0row + tid) * 16; float s = 0.f, q = 0.f;
#pragma unroll
        for (int k = 0; k < 8; ++k) { s += p[2 * k]; q += p[2 * k + 1]; }
        const float mean = s * (1.f / 512.f), var = fmaxf(q * (1.f / 512.f) - mean * mean, 0.f);
        stat[2 * tid] = mean; stat[2 * tid + 1] = rsqrtf(var + 1e-5f); }
    __syncthreads();
    bf16_t* Ks = (bf16_t*)lds; bf16_t* VT = (bf16_t*)(lds + 55296);
    const int kt0 = (c == 0) ? 8 : (c == 1 ? 4 : 0), key0 = kt0 * 16, nkeys = 192 - key0;
    for (int t = tid; t < nkeys * 16; t += 512) { const int kk = key0 + (t >> 4), ch = t & 15, kvh = ch >> 3, d8 = (ch & 7) * 8;
        *(u32x4*)(Ks + (size_t)(kvh * 192 + kk) * 72 + d8) = *(const u32x4*)(A.KB + (size_t)(row0 - 128 + kk) * 128 + kvh * 64 + d8); }
    { const int np = nkeys >> 1;
      for (int t = tid; t < np * 16; t += 512) { const int kp = t % np, ch = t / np, kk = key0 + 2 * kp;
        const bf16_t* v0 = A.VB + (size_t)(row0 - 128 + kk) * 128 + ch * 8; const u32x4 r0 = *(const u32x4*)v0, r1 = *(const u32x4*)(v0 + 128);
#pragma unroll
        for (int e = 0; e < 8; ++e) { const unsigned w0 = r0[e >> 1], w1 = r1[e >> 1]; const unsigned lo = (e & 1) ? (w0 >> 16) : (w0 & 0xffffu), hi = (e & 1) ? (w1 >> 16) : (w1 & 0xffffu);
            const int col = ch * 8 + e; *(unsigned*)(VT + (size_t)((col >> 6) * 64 + (col & 63)) * 200 + kk) = lo | (hi << 16); } } }
    __syncthreads();
    const int hB = wid, kvh = wid >> 2; const float sink = A.sinks[hB];
    f32x4 o[4][4];
#pragma unroll
    for (int x = 0; x < 4; ++x)
#pragma unroll
        for (int y = 0; y < 4; ++y) o[x][y] = (f32x4){0.f, 0.f, 0.f, 0.f};
#pragma unroll
    for (int qt = 0; qt < 4; ++qt) {
        bf16x8 qf[2];
#pragma unroll
        for (int ks = 0; ks < 2; ++ks) qf[ks] = *(const bf16x8*)(A.Q + (size_t)(row0 + qt * 16 + fr) * 512 + hB * 64 + ks * 32 + fq * 8);
        f32x4 s[12]; float mx = sink;
#pragma unroll
        for (int kt = 0; kt < 12; ++kt) { s[kt] = (f32x4){0.f, 0.f, 0.f, 0.f};
            if (kt >= kt0) {
#pragma unroll
                for (int ks = 0; ks < 2; ++ks) { const bf16x8 kf = *(const bf16x8*)(Ks + (size_t)(kvh * 192 + kt * 16 + fr) * 72 + ks * 32 + fq * 8);
                    s[kt] = __builtin_amdgcn_mfma_f32_16x16x32_bf16(kf, qf[ks], s[kt], 0, 0, 0); }
                mx = fmaxf(mx, fmaxf(fmaxf(s[kt][0], s[kt][1]), fmaxf(s[kt][2], s[kt][3]))); } }
        mx = fmaxf(mx, __shfl_xor(mx, 16)); mx = fmaxf(mx, __shfl_xor(mx, 32));
        float sum = 0.f;
#pragma unroll
        for (int kt = 0; kt < 12; ++kt) if (kt >= kt0) {
#pragma unroll
            for (int r = 0; r < 4; ++r) { const float e = __builtin_amdgcn_exp2f((s[kt][r] - mx) * LOG2E); s[kt][r] = e; sum += e; } }
        sum += __shfl_xor(sum, 16); sum += __shfl_xor(sum, 32);
        const float inv = 1.0f / (sum + __builtin_amdgcn_exp2f((sink - mx) * LOG2E));
#pragma unroll
        for (int st = 0; st < 6; ++st) if (2 * st >= kt0) {
            const f32x4 p0 = s[2 * st] * inv, p1 = s[2 * st + 1] * inv;
            u32x4 pw; pw.x = cvt_pk_bf16(p0[0], p0[1]); pw.y = cvt_pk_bf16(p0[2], p0[3]); pw.z = cvt_pk_bf16(p1[0], p1[1]); pw.w = cvt_pk_bf16(p1[2], p1[3]);
            const bf16x8 pf = __builtin_bit_cast(bf16x8, pw);
#pragma unroll
            for (int dt = 0; dt < 4; ++dt) { const bf16_t* vp = VT + (size_t)(kvh * 64 + dt * 16 + fr) * 200 + st * 32 + fq * 4;
                const u32x2 a0 = *(const u32x2*)vp, a1 = *(const u32x2*)(vp + 16); u32x4 aw; aw.x = a0.x; aw.y = a0.y; aw.z = a1.x; aw.w = a1.y;
                o[qt][dt] = __builtin_amdgcn_mfma_f32_16x16x32_bf16(__builtin_bit_cast(bf16x8, aw), pf, o[qt][dt], 0, 0, 0); } }
        float pb = 0.f;
#pragma unroll
        for (int dt = 0; dt < 4; ++dt) { const f32x4 y = o[qt][dt]; pb += (y[0] * y[0] + y[1] * y[1]) + (y[2] * y[2] + y[3] * y[3]); }
        pb += __shfl_xor(pb, 16); pb += __shfl_xor(pb, 32);
        if (fq == 0) ssqB[wid * 64 + qt * 16 + fr] = pb;
    }
    __syncthreads();
#pragma unroll
    for (int it = 0; it < 4; ++it) { const int i = it * 16 + fr; float sb = 0.f;
#pragma unroll
        for (int w = 0; w < 8; ++w) sb += ssqB[w * 64 + i];
        const float rB = rsqrtf(sb * (1.f / 512.f) + 1e-6f);
        bf16_t* mp = A.MIX + (size_t)(row0 + i) * DM + 512 + hB * 64 + fq * 4;
#pragma unroll
        for (int dt = 0; dt < 4; ++dt) *(u32x2*)(mp + dt * 16) = pack4(o[it][dt] * rB); }
    { const int npairs = nj >> 1, sh = (nj == 128) ? 6 : 5;
      for (int t = tid; t < 64 * npairs; t += 512) { const int jp = t & (npairs - 1), cgp = t >> sh, j = 2 * jp;
        const bf16_t* g0 = A.GV + (size_t)(j0row + j) * 512 + cgp * 8;
        const u32x4 r0 = *(const u32x4*)g0, r1 = *(const u32x4*)(g0 + 512);
        const float m0 = stat[2 * j], s0 = stat[2 * j + 1], m1 = stat[2 * j + 2], s1 = stat[2 * j + 3];
        const f32x4 g_lo = *(const f32x4*)(A.lng + cgp * 8), g_hi = *(const f32x4*)(A.lng + cgp * 8 + 4), b_lo = *(const f32x4*)(A.lnb + cgp * 8), b_hi = *(const f32x4*)(A.lnb + cgp * 8 + 4);
#pragma unroll
        for (int e = 0; e < 8; ++e) { const unsigned w0 = r0[e >> 1], w1 = r1[e >> 1]; const float x0 = (e & 1) ? bf_hi(w0) : bf_lo(w0), x1 = (e & 1) ? bf_hi(w1) : bf_lo(w1);
            const float g = e < 4 ? g_lo[e & 3] : g_hi[e & 3], bb = e < 4 ? b_lo[e & 3] : b_hi[e & 3];
            *(unsigned*)(gvT + (size_t)(cgp * 8 + e) * 136 + j) = pk2((x0 - m0) * s0 * g + bb, (x1 - m1) * s1 * g + bb); } } }
    __syncthreads();
    const int hA = wid >> 1, dh = wid & 1;
    f32x4 ya[4][4];
#pragma unroll
    for (int x = 0; x < 4; ++x)
#pragma unroll
        for (int y = 0; y < 4; ++y) ya[x][y] = (f32x4){0.f, 0.f, 0.f, 0.f};
    for (int ks = 0; ks < (nj >> 5); ++ks) {
        bf16x8 af[4], bf[4];
#pragma unroll
        for (int dt = 0; dt < 4; ++dt) af[dt] = *(const bf16x8*)(gvT + (size_t)(hA * 128 + dh * 64 + dt * 16 + fr) * 136 + ks * 32 + fq * 8);
#pragma unroll
        for (int it = 0; it < 4; ++it) bf[it] = *(const bf16x8*)(A.WM + (size_t)(hA * 128 + i0 + it * 16 + fr) * 128 + ks * 32 + fq * 8);
#pragma unroll
        for (int dt = 0; dt < 4; ++dt)
#pragma unroll
            for (int it = 0; it < 4; ++it) ya[dt][it] = __builtin_amdgcn_mfma_f32_16x16x32_bf16(af[dt], bf[it], ya[dt][it], 0, 0, 0);
    }
#pragma unroll
    for (int it = 0; it < 4; ++it) { const int i = it * 16 + fr; const float bsv = A.bs[hA * 128 + i0 + i]; float pa = 0.f;
#pragma unroll
        for (int dt = 0; dt < 4; ++dt) { const u32x2 w = *(const u32x2*)(A.U + (size_t)(row0 + i) * 512 + hA * 128 + dh * 64 + dt * 16 + fq * 4);
            f32x4 y = ya[dt][it]; y[0] = bf_lo(w.x) * (y[0] + bsv); y[1] = bf_hi(w.x) * (y[1] + bsv); y[2] = bf_lo(w.y) * (y[2] + bsv); y[3] = bf_hi(w.y) * (y[3] + bsv);
            ya[dt][it] = y; pa += (y[0] * y[0] + y[1] * y[1]) + (y[2] * y[2] + y[3] * y[3]); }
        pa += __shfl_xor(pa, 16); pa += __shfl_xor(pa, 32);
        if (fq == 0) ssqA[wid * 64 + i] = pa; }
    __syncthreads();
#pragma unroll
    for (int it = 0; it < 4; ++it) { const int i = it * 16 + fr; float sa = 0.f;
#pragma unroll
        for (int w = 0; w < 8; ++w) sa += ssqA[w * 64 + i];
        const float rA = rsqrtf(sa * (1.f / 512.f) + 1e-6f);
        bf16_t* mp = A.MIX + (size_t)(row0 + i) * DM + hA * 128 + dh * 64 + fq * 4;
#pragma unroll
        for (int dt = 0; dt < 4; ++dt) *(u32x2*)(mp + dt * 16) = pack4(ya[dt][it] * rA); }
    __syncthreads();
}

__device__ __forceinline__ void sample_item(unsigned char* lds, const Args& a, int sb, int tid, int wid, int lane) {
    float* su = (float*)lds;
    float* sg = su + 16 * 512;
    float* sq = sg + 16 * 512;
    float* skn = sq + 16 * 512;
    float* svn = skn + 16 * 128;
    float* spb = svn + 16 * 128;
    const float* ZS = (const float*)(a.ws + WS_ZS); const float* rope = (const float*)(a.ws + WS_ROPE);
    bf16_t* MIX = (bf16_t*)(a.ws + WS_MIX);
    for (int idx = tid; idx < 16 * INW; idx += 512) { const int i = idx / INW, cc = idx % INW; const int pc = cc < 1024 ? cc : ((cc & ~255) | swap45(cc & 255));
        const float z = ZS[(size_t)(sb * 16 + i) * INW + pc];
        if (cc < 512) su[i * 512 + cc] = gelu_f(z);
        else if (cc < 1024) sg[i * 512 + cc - 512] = gelu_f(z);
        else if (cc < 1536) sq[i * 512 + cc - 1024] = z;
        else if (cc < 1664) skn[i * 128 + cc - 1536] = z;
        else { svn[i * 128 + cc - 1664] = z; a.out[O_SV + (size_t)(sb * 16 + i) * 128 + cc - 1664] = z; } }
    __syncthreads();
    for (int i = wid; i < 16; i += 8) { float v[8], s = 0.f;
#pragma unroll
        for (int k = 0; k < 8; ++k) { v[k] = sg[i * 512 + lane + 64 * k]; s += v[k]; }
        const float mean = wave_sum(s) * (1.f / 512.f); float q = 0.f;
#pragma unroll
        for (int k = 0; k < 8; ++k) { v[k] -= mean; q += v[k] * v[k]; }
        const float rstd = rsqrtf(wave_sum(q) * (1.f / 512.f) + 1e-5f);
#pragma unroll
        for (int k = 0; k < 8; ++k) { const int cc = lane + 64 * k; const float y = v[k] * rstd * a.in[I_GLG][cc] + a.in[I_GLB][cc]; sg[i * 512 + cc] = y; a.out[O_SG + (size_t)(sb * 16 + i) * 512 + cc] = y; } }
    for (int t = tid; t < 16 * 10 * 32; t += 512) { const int d = t & 31, hh = (t >> 5) % 10, i = t / 320, pos = 2048 + i;
        const float cs = rope[(size_t)pos * 32 + d], sn = rope[(size_t)SEQ * 32 + (size_t)pos * 32 + d];
        if (hh < 8) { float* p = sq + i * 512 + hh * 64 + d; const float x1 = p[0], x2 = p[32]; p[0] = (x1 * cs - x2 * sn) * 0.125f; p[32] = (x2 * cs + x1 * sn) * 0.125f; }
        else { float* p = skn + i * 128 + (hh - 8) * 64 + d; const float x1 = p[0], x2 = p[32], o1 = x1 * cs - x2 * sn, o2 = x2 * cs + x1 * sn; p[0] = o1; p[32] = o2;
            float* op = a.out + O_SK + (size_t)(sb * 16 + i) * 128 + (hh - 8) * 64 + d; op[0] = o1; op[32] = o2; } }
    __syncthreads();
    for (int t = tid; t < 16 * 512; t += 512) { const int i = t >> 9, cc = t & 511, h = cc >> 7; float s = a.in[I_BS][h * 128 + i];
#pragma unroll
        for (int j = 0; j < 16; ++j) s += a.in[I_WS][(size_t)(h * 128 + i) * 128 + j] * sg[j * 512 + cc];
        su[t] = su[t] * s; }
    for (int pr = wid; pr < 128; pr += 8) { const int i = pr >> 3, h = pr & 7, kvh = h >> 2; const float sink = a.in[I_SINK][h];
        const float* qv = sq + i * 512 + h * 64; float sc[3]; float mx = sink;
#pragma unroll
        for (int k = 0; k < 3; ++k) { const int key = lane + 64 * k; float d = -INFINITY;
            if (key < 144) { d = 0.f; const float* kp = key < 128 ? a.in[I_CK] + ((size_t)(sb * 128 + key) * 2 + kvh) * 64 : skn + (key - 128) * 128 + kvh * 64;
                for (int e = 0; e < 64; ++e) d += qv[e] * kp[e]; }
            sc[k] = d; mx = fmaxf(mx, d); }
#pragma unroll
        for (int o = 1; o < 64; o <<= 1) mx = fmaxf(mx, __shfl_xor(mx, o));
        float sum = 0.f;
#pragma unroll
        for (int k = 0; k < 3; ++k) { sc[k] = (lane + 64 * k < 144) ? __expf(sc[k] - mx) : 0.f; sum += sc[k]; }
        sum = wave_sum(sum); const float inv = 1.0f / (sum + __expf(sink - mx));
#pragma unroll
        for (int k = 0; k < 3; ++k) if (lane + 64 * k < 144) spb[wid * 160 + lane + 64 * k] = sc[k] * inv;
        asm volatile("s_waitcnt lgkmcnt(0)" ::: "memory");
        float ov = 0.f;
        for (int key = 0; key < 144; ++key) { const float vv = key < 128 ? a.in[I_CV][((size_t)(sb * 128 + key) * 2 + kvh) * 64 + lane] : svn[(key - 128) * 128 + kvh * 64 + lane];
            ov += spb[wid * 160 + key] * vv; }
        asm volatile("s_waitcnt lgkmcnt(0)" ::: "memory");
        sq[i * 512 + h * 64 + lane] = ov; }
    __syncthreads();
    for (int i = wid; i < 16; i += 8) { float va[8], vb[8], qa = 0.f, qb = 0.f;
#pragma unroll
        for (int k = 0; k < 8; ++k) { va[k] = su[i * 512 + lane + 64 * k]; vb[k] = sq[i * 512 + lane + 64 * k]; qa += va[k] * va[k]; qb += vb[k] * vb[k]; }
        const float rA = rsqrtf(wave_sum(qa) * (1.f / 512.f) + 1e-6f), rB = rsqrtf(wave_sum(qb) * (1.f / 512.f) + 1e-6f);
        bf16_t* mp = MIX + (size_t)(MPR + sb * 16 + i) * DM;
#pragma unroll
        for (int k = 0; k < 8; ++k) { mp[lane + 64 * k] = (bf16_t)f2bf(va[k] * rA); mp[512 + lane + 64 * k] = (bf16_t)f2bf(vb[k] * rB); } }
    __syncthreads();
}

__device__ __forceinline__ void ln_stats(f32x4 (&v)[4], float& rstd) {
    float s = 0.f;
#pragma unroll
    for (int j = 0; j < 4; ++j) s += (v[j][0] + v[j][1]) + (v[j][2] + v[j][3]);
    const float mean = wave_sum(s) * (1.f / DM); float q = 0.f;
#pragma unroll
    for (int j = 0; j < 4; ++j) { v[j] = v[j] - mean; q += (v[j][0] * v[j][0] + v[j][1] * v[j][1]) + (v[j][2] * v[j][2] + v[j][3] * v[j][3]); }
    rstd = rsqrtf(wave_sum(q) * (1.f / DM) + 1e-5f);
}
__device__ __forceinline__ void p3b_ln1(const Args& a, int wid, int lane) {
    const float* H1 = (const float*)(a.ws + WS_H1); const float* M1S = (const float*)(a.ws + WS_M1S); bf16_t* X1 = (bf16_t*)(a.ws + WS_X1);
    const float* g = a.in[I_L1G]; const float* bb = a.in[I_L1B];
    f32x4 gv[4], bv[4];
#pragma unroll
    for (int j = 0; j < 4; ++j) { gv[j] = *(const f32x4*)(g + 4 * (64 * j + lane)); bv[j] = *(const f32x4*)(bb + 4 * (64 * j + lane)); }
    for (int row = blockIdx.x * 8 + wid; row < MROWS; row += gridDim.x * 8) { f32x4 v[4];
        if (row < MPR) {
#pragma unroll
            for (int j = 0; j < 4; ++j) v[j] = *(const f32x4*)(H1 + (size_t)row * DM + 4 * (64 * j + lane));
        } else { const size_t so = (size_t)(row - MPR) * DM;
#pragma unroll
            for (int j = 0; j < 4; ++j) v[j] = *(const f32x4*)(a.in[I_XS] + so + 4 * (64 * j + lane)) * ALPHA + *(const f32x4*)(M1S + so + 4 * (64 * j + lane)); }
        float rstd; ln_stats(v, rstd);
#pragma unroll
        for (int j = 0; j < 4; ++j) *(u32x2*)(X1 + (size_t)row * DM + 4 * (64 * j + lane)) = pack4(v[j] * rstd * gv[j] + bv[j]); }
}
__device__ __forceinline__ void p5b_ln2(const Args& a, int wid, int lane) {
    const float* FS = (const float*)(a.ws + WS_FS); const bf16_t* X1 = (const bf16_t*)(a.ws + WS_X1);
    const float* g = a.in[I_L2G]; const float* bb = a.in[I_L2B];
    f32x4 gv[4], bv[4];
#pragma unroll
    for (int j = 0; j < 4; ++j) { gv[j] = *(const f32x4*)(g + 4 * (64 * j + lane)); bv[j] = *(const f32x4*)(bb + 4 * (64 * j + lane)); }
    for (int row = blockIdx.x * 8 + wid; row < MROWS; row += gridDim.x * 8) { f32x4 v[4]; float* op;
        if (row < MPR) { op = a.out + O_YP + (size_t)row * DM;
#pragma unroll
            for (int j = 0; j < 4; ++j) v[j] = *(const f32x4*)(op + 4 * (64 * j + lane));
        } else { const size_t so = (size_t)(row - MPR) * DM; op = a.out + O_YS + so;
#pragma unroll
            for (int j = 0; j < 4; ++j) { const u32x2 w = *(const u32x2*)(X1 + (size_t)row * DM + 4 * (64 * j + lane));
                v[j] = (f32x4){bf_lo(w.x), bf_hi(w.x), bf_lo(w.y), bf_hi(w.y)} * ALPHA + *(const f32x4*)(FS + so + 4 * (64 * j + lane)); } }
        float rstd; ln_stats(v, rstd);
#pragma unroll
        for (int j = 0; j < 4; ++j) *(f32x4*)(op + 4 * (64 * j + lane)) = v[j] * rstd * gv[j] + bv[j]; }
}

__device__ __forceinline__ void p4b_fix(const Args& a, int tid) {
    const float* AHEAD = (const float*)(a.ws + WS_AHEAD); const float* BHEAD = (const float*)(a.ws + WS_BHEAD); const float* ATAIL = (const float*)(a.ws + WS_ATAIL);
    const float* C4S = (const float*)(a.ws + WS_C4S); bf16_t* HH = (bf16_t*)(a.ws + WS_HH);
    const float* cw = a.in[I_CW]; const float* cb = a.in[I_CB]; const float* st = a.in[I_ST];
    const size_t gt = (size_t)blockIdx.x * 512 + tid, NT = (size_t)gridDim.x * 512;
    for (size_t idx = gt; idx < (size_t)256 * 2 * FFD; idx += NT) { const int f = (int)(idx % FFD), rr = (int)(idx / FFD) & 1, pm = (int)(idx / (2 * FFD));
        const float a0 = AHEAD[idx], up = BHEAD[idx]; float p1 = 0.f, p2 = 0.f;
        if (pm & 15) { const float* tl = ATAIL + (size_t)(pm - 1) * 2 * FFD; if (rr == 0) { p1 = tl[FFD + f]; p2 = tl[f]; } else { p1 = AHEAD[(size_t)pm * 2 * FFD + f]; p2 = tl[FFD + f]; } }
        else if (rr) p1 = AHEAD[(size_t)pm * 2 * FFD + f];
        const float c = cw[f] * p2 + cw[FFD + f] * p1 + cw[2 * FFD + f] * a0 + cb[f];
        HH[(size_t)(pm * 256 + rr) * FFD + f] = (bf16_t)f2bf(gelu_f(c) * up); }
    for (size_t idx = gt; idx < (size_t)16 * 2 * FFD; idx += NT) { const int b = (int)(idx / (2 * FFD)); a.out[O_PC + idx] = ATAIL[(size_t)(16 * b + 15) * 2 * FFD + idx % (2 * FFD)]; }
    for (size_t idx = gt; idx < (size_t)MSA * FFD; idx += NT) { const int f = (int)(idx % FFD), r = (int)(idx / FFD), b = r >> 4, t = r & 15, pos = ((f >> 7) << 8) + (f & 127);
        const float a0 = C4S[(size_t)r * GUW + pos], up = C4S[(size_t)r * GUW + pos + 128];
        const float p1 = t >= 1 ? C4S[(size_t)(r - 1) * GUW + pos] : st[(size_t)(b * 2 + 1) * FFD + f];
        const float p2 = t >= 2 ? C4S[(size_t)(r - 2) * GUW + pos] : st[(size_t)(b * 2 + t) * FFD + f];
        const float c = cw[f] * p2 + cw[FFD + f] * p1 + cw[2 * FFD + f] * a0 + cb[f];
        HH[(size_t)(MPR + r) * FFD + f] = (bf16_t)f2bf(gelu_f(c) * up); }
    for (size_t idx = gt; idx < (size_t)8 * 2 * FFD; idx += NT) { const int f = (int)(idx % FFD), i = (int)(idx / FFD) & 1, b = (int)(idx / (2 * FFD)), pos = ((f >> 7) << 8) + (f & 127);
        a.out[O_SC + idx] = C4S[(size_t)(b * 16 + 14 + i) * GUW + pos]; }
}

constexpr int NPHASE = 9;
__global__ void __launch_bounds__(512, 2) fwd_kernel(Args a) {
    extern __shared__ __attribute__((aligned(16))) unsigned char lds[];
    LAS unsigned char* ldsl = (LAS unsigned char*)lds;
    const int tid = threadIdx.x, lane = tid & 63, wid = __builtin_amdgcn_readfirstlane(tid >> 6);
    const int lo = a.ph_lo, hi = a.ph_hi, G = gridDim.x;
    unsigned char* ws = a.ws;
#define IN(k) (lo <= (k) && (k) < hi)
#if MK_MULTI
#define SEAM(k) do { } while (0)
#else
#define SEAM(k) do { if (IN(k) && IN((k) + 1)) { cg::this_grid().sync(); } } while (0)
#endif
    bf16_t* XB = (bf16_t*)(ws + WS_XB); bf16_t* MIX = (bf16_t*)(ws + WS_MIX); bf16_t* X1 = (bf16_t*)(ws + WS_X1); bf16_t* HH = (bf16_t*)(ws + WS_HH);
    if (IN(0)) { p0_prologue(a, lds, tid, wid, lane); __syncthreads(); }
    SEAM(0);
    if (IN(1)) {
        skinny_gemm(XB + (size_t)MPR * DM, (const bf16_t*)(ws + WS_WINT), (float*)(ws + WS_ZS), INW, DM, wid, lane);
        pg8::Gemm g{XB, (const bf16_t*)(ws + WS_WINT), MPR, INW, DM}; pg8::StaticOrder S; S.init(MPR, INW, G, (int)blockIdx.x);
        Epi1 E{(bf16_t*)(ws + WS_U), (bf16_t*)(ws + WS_GV), (bf16_t*)(ws + WS_Q), (bf16_t*)(ws + WS_K), (bf16_t*)(ws + WS_V), (float*)(ws + WS_GVP), (const float*)(ws + WS_ROPE), a.out};
        pg8::gemm_phase<Epi1>(ldsl, g, S, E);
    }
    SEAM(1);
    if (IN(2)) {
        P2Args A{(const bf16_t*)(ws + WS_U), (const bf16_t*)(ws + WS_GV), (const bf16_t*)(ws + WS_Q), (const bf16_t*)(ws + WS_K), (const bf16_t*)(ws + WS_V), (const bf16_t*)(ws + WS_WM),
                 (const float*)(ws + WS_GVP), a.in[I_GLG], a.in[I_GLB], a.in[I_BS], a.in[I_SINK], MIX};
        if ((int)blockIdx.x >= G - 8) sample_item(lds, a, (int)blockIdx.x - (G - 8), tid, wid, lane);
        for (int it = blockIdx.x; it < 1024; it += G) mixer_item(lds, A, it, tid, wid, lane);
    }
    SEAM(2);
    if (IN(3)) {
        skinny_gemm(MIX + (size_t)MPR * DM, (const bf16_t*)(ws + WS_WOUTT), (float*)(ws + WS_M1S), DM, DM, wid, lane);
        pg8::Gemm g{MIX, (const bf16_t*)(ws + WS_WOUTT), MPR, DM, DM}; pg8::StaticOrder S; S.init(MPR, DM, G, (int)blockIdx.x);
        Epi3 E{a.in[I_XP], (float*)(ws + WS_H1)};
        pg8::gemm_phase<Epi3>(ldsl, g, S, E);
    }
    SEAM(3);
    if (IN(4)) p3b_ln1(a, wid, lane);
    SEAM(4);
    if (IN(5)) {
        skinny_gemm(X1 + (size_t)MPR * DM, (const bf16_t*)(ws + WS_WGUT), (float*)(ws + WS_C4S), GUW, DM, wid, lane);
        pg8::Gemm g{X1, (const bf16_t*)(ws + WS_WGUT), MPR, GUW, DM}; pg8::StaticOrder S; S.init(MPR, GUW, G, (int)blockIdx.x);
        Epi4 E{HH, (float*)(ws + WS_AHEAD), (float*)(ws + WS_BHEAD), (float*)(ws + WS_ATAIL), a.in[I_CW], a.in[I_CB]};
        pg8::gemm_phase<Epi4>(ldsl, g, S, E);
    }
    SEAM(5);
    if (IN(6)) p4b_fix(a, tid);
    SEAM(6);
    if (IN(7)) {
        skinny_gemm(HH + (size_t)MPR * FFD, (const bf16_t*)(ws + WS_WDNT), (float*)(ws + WS_FS), DM, FFD, wid, lane);
        pg8::Gemm g{HH, (const bf16_t*)(ws + WS_WDNT), MPR, DM, FFD}; pg8::StaticOrder S; S.init(MPR, DM, G, (int)blockIdx.x);
        Epi5 E{X1, a.out + O_YP};
        pg8::gemm_phase<Epi5>(ldsl, g, S, E);
    }
    SEAM(7);
    if (IN(8)) p5b_ln2(a, wid, lane);
#undef IN
#undef SEAM
}

extern "C" void kernel_launch(void* const* d_in, const int* in_sizes, int n_in, void* d_out, int out_size, void* d_ws, size_t ws_size, hipStream_t stream) {
    static int grid = 0;
    if (grid == 0) {
        if (n_in != 23 || (size_t)out_size != O_END || ws_size < WS_END) { fprintf(stderr, "kernel_launch: unexpected shapes (n_in %d, out %d, ws %zu)\n", n_in, out_size, ws_size); grid = -1; return; }
        int dev = 0, cus = 0, per_cu = 0;
        (void)hipGetDevice(&dev); (void)hipDeviceGetAttribute(&cus, hipDeviceAttributeMultiprocessorCount, dev);
        if (hipFuncSetAttribute((const void*)fwd_kernel, hipFuncAttributeMaxDynamicSharedMemorySize, LDS_BYTES) != hipSuccess) { fprintf(stderr, "kernel_launch: hipFuncSetAttribute failed\n"); grid = -1; return; }
        if (hipOccupancyMaxActiveBlocksPerMultiprocessor(&per_cu, (const void*)fwd_kernel, 512, LDS_BYTES) != hipSuccess || per_cu < 1) { fprintf(stderr, "kernel_launch: occupancy query says %d\n", per_cu); per_cu = 1; }
        (void)hipGetLastError();
        grid = cus > 0 ? cus : 256;
    }
    if (grid < 0) return;
    Args a{};
    for (int i = 0; i < 23; ++i) a.in[i] = (const float*)d_in[i];
    a.out = (float*)d_out; a.ws = (unsigned char*)d_ws;
#if MK_MULTI
    for (int p = 0; p < NPHASE; ++p) { a.ph_lo = p; a.ph_hi = p + 1; hipLaunchKernelGGL(fwd_kernel, dim3(grid), dim3(512), LDS_BYTES, stream, a); }
#else
    a.ph_lo = 0; a.ph_hi = NPHASE;
    void* args[] = {&a};
    const hipError_t e = hipLaunchCooperativeKernel((const void*)fwd_kernel, dim3(grid), dim3(512), args, LDS_BYTES, stream);
    if (e != hipSuccess) fprintf(stderr, "kernel_launch: cooperative launch failed: %s (grid %d)\n", hipGetErrorString(e), grid);
#endif
}
```
